# Optimizing an MI355X kernel written in HIP

```python
import math
import jax
import jax.numpy as jnp
from jax import lax
import numpy as np

D_MODEL = 2048
BATCH = 4
SEQ = 4096
DEPTH = 2

D_MIX = D_MODEL
GLA_HEADS = 4
GLA_DK = D_MIX // 16
GLA_DV = D_MIX // 8
GLA_GATE_RANK = 16
GLA_GATE_TAU = 16.0
GLA_CHUNK = 64
DSA_HEADS = 8
DSA_HEAD_DIM = 128
IDX_HEADS = 16
IDX_DIM = 64
DSA_TOPK_MAX = 256
DSA_Q_BLOCK = 64
ROPE_THETA = 500000.0
ROPE_FRACTION = 4
D_FF = 4 * D_MODEL
EPS = 1e-6
NEG_INF = -1e30

IN_SPLITS = (
    GLA_HEADS * GLA_DK,
    GLA_HEADS * GLA_DK,
    GLA_HEADS * GLA_DV,
    GLA_HEADS * GLA_DV,
    GLA_GATE_RANK,
    DSA_HEADS * DSA_HEAD_DIM,
    DSA_HEADS * DSA_HEAD_DIM,
    DSA_HEADS * DSA_HEAD_DIM,
    IDX_HEADS * IDX_DIM,
    IDX_DIM,
    IDX_HEADS,
)
D_IN = sum(IN_SPLITS)

kernel_name = "hybrid_gla_dsa_sandwich_trunk"


def rms_norm(x, g):
    xf = x.astype(jnp.float32)
    y = xf * lax.rsqrt(jnp.mean(xf * xf, axis=-1, keepdims=True) + EPS)
    return (y * g.astype(jnp.float32)).astype(x.dtype)


def rope_tables(positions, head_dim):
    r = head_dim // ROPE_FRACTION
    inv_freq = ROPE_THETA ** (-(jnp.arange(0, r, 2, dtype=jnp.float32) / r))
    ang = positions.astype(jnp.float32)[..., None] * inv_freq
    return jnp.cos(ang)[:, :, None, :], jnp.sin(ang)[:, :, None, :]


def apply_partial_rope(x, cos, sin):
    r = 2 * cos.shape[-1]
    xr = x[..., :r].astype(jnp.float32)
    x1, x2 = xr[..., : r // 2], xr[..., r // 2:]
    rot = jnp.concatenate([x1 * cos - x2 * sin, x2 * cos + x1 * sin], axis=-1)
    return jnp.concatenate([rot.astype(x.dtype), x[..., r:]], axis=-1)


def gla_chunked(q, k, v, log_a):
    B, S, H, DK = q.shape
    DV = v.shape[-1]
    C = GLA_CHUNK
    N = S // C

    def to_chunks(t):
        return t.reshape(B, N, C, H, t.shape[-1]).transpose(0, 3, 1, 2, 4).astype(jnp.float32)

    qc = to_chunks(q) * (DK ** -0.5)
    kc, vc, gc = to_chunks(k), to_chunks(v), to_chunks(log_a)
    b = jnp.cumsum(gc, axis=3)
    b_last = b[:, :, :, -1:, :]
    q_dec = qc * jnp.exp(b)
    k_inv = kc * jnp.exp(-b)
    k_dec = kc * jnp.exp(b_last - b)
    causal = jnp.tril(jnp.ones((C, C), dtype=bool))
    attn = jnp.where(causal, jnp.einsum('bhncd,bhnjd->bhncj', q_dec, k_inv), 0.0)
    o_intra = jnp.einsum('bhncj,bhnje->bhnce', attn, vc)
    d_state = jnp.einsum('bhncd,bhnce->bhnde', k_dec, vc)
    decay = jnp.exp(b_last[:, :, :, 0, :])

    def step(state, inp):
        dec, ds = inp
        return dec[..., None] * state + ds, state

    _, states = lax.scan(step, jnp.zeros((B, H, DK, DV), jnp.float32),
                         (decay.transpose(2, 0, 1, 3), d_state.transpose(2, 0, 1, 3, 4)))
    states = states.transpose(1, 2, 0, 3, 4)
    o = o_intra + jnp.einsum('bhncd,bhnde->bhnce', q_dec, states)
    return o.transpose(0, 2, 3, 1, 4).reshape(B, S, H, DV).astype(v.dtype)


def dsa_attention(q, k, v, iq, ik, iw):
    B, S, H, Dh = q.shape
    QB = DSA_Q_BLOCK
    NB = S // QB
    topk = min(DSA_TOPK_MAX, S // 4)
    key_pos = jnp.arange(S)
    iw = iw * (IDX_HEADS ** -0.5)

    def blocks(t):
        return t.reshape((B, NB, QB) + t.shape[2:]).swapaxes(0, 1)

    def one_block(args):
        qb, iqb, iwb, start = args
        qpos = start + jnp.arange(QB)
        logits = jnp.einsum('bqhd,bsd->bqsh', iqb, ik) * (IDX_DIM ** -0.5)
        score = jnp.einsum('bqsh,bqh->bqs', jax.nn.relu(logits), iwb).astype(jnp.float32)
        visible = key_pos[None, :] <= qpos[:, None]
        score = jnp.where(visible[None], score, NEG_INF)
        _, sel = lax.top_k(score, topk)
        k_sel = jax.vmap(lambda kb, ib: kb[ib])(k, sel)
        v_sel = jax.vmap(lambda vb, ib: vb[ib])(v, sel)
        s = jnp.einsum('bqhd,bqkhd->bqhk', qb, k_sel).astype(jnp.float32) * (Dh ** -0.5)
        valid = (sel <= qpos[None, :, None])[:, :, None, :]
        p = jax.nn.softmax(jnp.where(valid, s, NEG_INF), axis=-1)
        return jnp.einsum('bqhk,bqkhd->bqhd', p.astype(v.dtype), v_sel)

    starts = jnp.arange(NB, dtype=jnp.int32) * QB
    out = lax.map(one_block, (blocks(q), blocks(iq), blocks(iw), starts))
    return out.swapaxes(0, 1).reshape(B, S, H, Dh)


def hybrid_mixer(h, cos_a, sin_a, cos_i, sin_i, w_in, gla_wa2, gla_ba, gla_norm, w_out):
    B, S, _ = h.shape
    proj = h @ w_in
    points = np.cumsum(IN_SPLITS)[:-1].tolist()
    gq, gk, gv, gg, gr, dq, dk, dv, iq, ik, iw = jnp.split(proj, points, axis=-1)

    log_a = jax.nn.log_sigmoid((gr @ gla_wa2 + gla_ba).astype(jnp.float32)) / GLA_GATE_TAU
    o_gla = gla_chunked(gq.reshape(B, S, GLA_HEADS, GLA_DK), gk.reshape(B, S, GLA_HEADS, GLA_DK),
                        gv.reshape(B, S, GLA_HEADS, GLA_DV), log_a.reshape(B, S, GLA_HEADS, GLA_DK))
    o_gla = rms_norm(o_gla, gla_norm) * jax.nn.silu(gg.reshape(B, S, GLA_HEADS, GLA_DV))

    dq = apply_partial_rope(dq.reshape(B, S, DSA_HEADS, DSA_HEAD_DIM), cos_a, sin_a)
    dk = apply_partial_rope(dk.reshape(B, S, DSA_HEADS, DSA_HEAD_DIM), cos_a, sin_a)
    dv = dv.reshape(B, S, DSA_HEADS, DSA_HEAD_DIM)
    iq = apply_partial_rope(iq.reshape(B, S, IDX_HEADS, IDX_DIM), cos_i, sin_i)
    ik = apply_partial_rope(ik[:, :, None, :], cos_i, sin_i)[:, :, 0, :]
    o_dsa = dsa_attention(dq, dk, dv, iq, ik, iw)

    o = jnp.concatenate([o_gla.reshape(B, S, -1), o_dsa.reshape(B, S, -1)], axis=-1)
    return o @ w_out


def sq_relu_mlp(h, w_up, w_down):
    u = jax.nn.relu(h @ w_up)
    return (u * u) @ w_down


def setup_inputs(seed: int = 0) -> dict:
    key = jax.random.key(seed)
    ks = jax.random.split(key, 16)
    f32 = jnp.float32

    def gain(k, shape):
        return 1.0 + 0.02 * jax.random.normal(k, shape, f32)

    def dense(k, shape, fan_in):
        return jax.random.normal(k, shape, f32) * (fan_in ** -0.5)

    x = jax.random.normal(ks[0], (BATCH, SEQ, D_MODEL), f32)
    positions = jnp.broadcast_to(jnp.arange(SEQ, dtype=jnp.int32)[None, :], (BATCH, SEQ))
    return {
        "x": x,
        "positions": positions,
        "norm_mix_pre": gain(ks[1], (DEPTH, D_MODEL)),
        "w_in": dense(ks[2], (DEPTH, D_MODEL, D_IN), D_MODEL),
        "gla_wa2": dense(ks[3], (DEPTH, GLA_GATE_RANK, GLA_HEADS * GLA_DK), GLA_GATE_RANK),
        "gla_ba": 0.02 * jax.random.normal(ks[4], (DEPTH, GLA_HEADS * GLA_DK), f32),
        "gla_norm": gain(ks[5], (DEPTH, GLA_DV)),
        "w_out": dense(ks[6], (DEPTH, D_MIX, D_MODEL), D_MIX),
        "norm_mix_post": gain(ks[7], (DEPTH, D_MODEL)),
        "norm_ffn_pre": gain(ks[8], (DEPTH, D_MODEL)),
        "w_up": dense(ks[9], (DEPTH, D_MODEL, D_FF), D_MODEL),
        "w_down": dense(ks[10], (DEPTH, D_FF, D_MODEL), D_FF),
        "norm_ffn_post": gain(ks[11], (DEPTH, D_MODEL)),
    }


def reference(x, positions, norm_mix_pre, w_in, gla_wa2, gla_ba, gla_norm, w_out,
              norm_mix_post, norm_ffn_pre, w_up, w_down, norm_ffn_post):
    cos_a, sin_a = rope_tables(positions, DSA_HEAD_DIM)
    cos_i, sin_i = rope_tables(positions, IDX_DIM)
    h = x
    for l in range(DEPTH):
        m = hybrid_mixer(rms_norm(h, norm_mix_pre[l]), cos_a, sin_a, cos_i, sin_i,
                         w_in[l], gla_wa2[l], gla_ba[l], gla_norm[l], w_out[l])
        h = h + rms_norm(m, norm_mix_post[l])
        f = sq_relu_mlp(rms_norm(h, norm_ffn_pre[l]), w_up[l], w_down[l])
        h = h + rms_norm(f, norm_ffn_post[l])
    return h
```

```cpp
#include <hip/hip_runtime.h>
#include <cstdio>
#include <cstdint>
namespace pg8 {
#define PG8_LAS __attribute__((address_space(3)))
typedef unsigned short bf16_t;
typedef short bf16x8 __attribute__((ext_vector_type(8)));
typedef float f32x4 __attribute__((ext_vector_type(4)));
typedef unsigned u32x4 __attribute__((ext_vector_type(4)));
constexpr int BM = 256, BK = 64, HALF = 128, HTB = HALF * BK * 2  , STAGE_BYTES = 8 * HTB, NXCD = 8, WGM = 8;

__host__ __device__ __forceinline__ int lds_byte(int r, int c) { const int st = (r >> 4) * 2 + (c >> 5), rr = r & 15, cc = c & 31, ob = rr * 64 + cc * 2; return st * 1024 + (ob ^ (((ob >> 9) & 1) << 5)); }
__host__ __device__ __forceinline__ void stage_rc(int b, int& R, int& C) { const int st = b / 1024, sb = b % 1024, swz = sb ^ (((sb >> 9) & 1) << 5); R = (st >> 1) * 16 + swz / 64; C = (st & 1) * 32 + (swz % 64) / 2; }
__host__ __device__ __forceinline__ int perm32(int rho) { const int n = rho >> 4, i = rho & 15; return 8 * (i >> 2) + 4 * n + (i & 3); }

struct Unit { int pm, pn; };
struct Gemm { const bf16_t* A; const bf16_t* Bt; int M, N, K, lda; };

struct StaticOrder {
    int nM, nN, nwg, G, c;
    __host__ __device__ void init(int M, int N, int G_, int c_) { nM = M / BM; nN = N / BM; nwg = nM * nN; G = G_; c = c_; }
    __host__ __device__ bool next(int i, Unit& u) const {
        const long L = (long)i * G + c; if (L >= nwg) return false;
        int wgid = (int)L; { const int q = nwg / NXCD, r = nwg % NXCD, xcd = wgid % NXCD, off = wgid / NXCD; wgid = (xcd < r ? xcd * (q + 1) : r * (q + 1) + (xcd - r) * q) + off; }
        const int nig = WGM * nN, gid = wgid / nig, fm = gid * WGM, gsz = (nM - fm) < WGM ? (nM - fm) : WGM;
        u.pm = fm + ((wgid % nig) % gsz); u.pn = (wgid % nig) / gsz; return true;
    }
    __device__ __forceinline__ void a_ready(const Unit&) const {}
    __device__ __forceinline__ void done(const Unit&) const {}
};

__device__ __forceinline__ unsigned cvt_pk_bf16(float lo, float hi) { unsigned r; asm volatile("v_cvt_pk_bf16_f32 %0, %1, %2" : "=v"(r) : "v"(lo), "v"(hi)); return r; }
typedef float f32x2 __attribute__((ext_vector_type(2)));
template <int ACT  > struct EpiStore {
    static constexpr bool PERM = true, AFTER_DRAIN = false;
    bf16_t* O; int ldc;
    __device__ __forceinline__ void operator()(const f32x4 (&acc)[2][2][4][2], const Unit& u, int wr, int wc, int fr, int fq) const {
        const int row0 = u.pm * BM + wr * 64 + fr; const int col0 = u.pn * BM + wc * 32 + 8 * fq;
#pragma unroll
        for (int ai = 0; ai < 2; ++ai)
#pragma unroll
            for (int m = 0; m < 4; ++m) { bf16_t* rowp = O + (size_t)(row0 + ai * HALF + m * 16) * ldc + col0;
#pragma unroll
                for (int bj = 0; bj < 2; ++bj) { f32x4 v0 = acc[ai][bj][m][0], v1 = acc[ai][bj][m][1];
                    if (ACT == 2) {
#pragma unroll
                        for (int e = 0; e < 4; ++e) { const float a = fmaxf(v0[e], 0.f), b = fmaxf(v1[e], 0.f); v0[e] = a * a; v1[e] = b * b; } }
                    u32x4 w; w.x = cvt_pk_bf16(v0[0], v0[1]); w.y = cvt_pk_bf16(v0[2], v0[3]); w.z = cvt_pk_bf16(v1[0], v1[1]); w.w = cvt_pk_bf16(v1[2], v1[3]);
                    *(u32x4*)(rowp + bj * HALF) = w; } }
    }
};
struct EpiIn {
    static constexpr bool PERM = true, AFTER_DRAIN = false;
    bf16_t* P; float* SM; bf16_t* IKB; const float* CA; const float* SA; const float* CI; const float* SI;
    __device__ __forceinline__ void operator()(const f32x4 (&acc)[2][2][4][2], const Unit& u, int wr, int wc, int fr, int fq) const {
        const int row0 = u.pm * BM + wr * 64 + fr; const int pn = u.pn;
        if (pn < 28) {
            const bool dsa = (pn >= 12 && pn < 20) && (wc == 0);
            const bool idx = (pn >= 24) && ((wc & 1) == 0) && (fq < 2);
            const int col0 = pn * BM + wc * 32 + 8 * fq;
#pragma unroll
            for (int ai = 0; ai < 2; ++ai)
#pragma unroll
                for (int m = 0; m < 4; ++m) { const int row = row0 + ai * HALF + m * 16;
                    f32x4 c4 = (f32x4){1.f, 1.f, 1.f, 1.f}, s4 = (f32x4){0.f, 0.f, 0.f, 0.f};
                    if (dsa) { c4 = *(const f32x4*)(CA + (size_t)row * 16 + 4 * fq); s4 = *(const f32x4*)(SA + (size_t)row * 16 + 4 * fq); }
                    else if (idx) { c4 = *(const f32x4*)(CI + (size_t)row * 8 + 4 * fq); s4 = *(const f32x4*)(SI + (size_t)row * 8 + 4 * fq); }
                    bf16_t* rowp = P + (size_t)row * 7168 + col0;
#pragma unroll
                    for (int bj = 0; bj < 2; ++bj) { const f32x4 x1 = acc[ai][bj][m][0], x2 = acc[ai][bj][m][1];
                        const f32x4 v0 = x1 * c4 - x2 * s4, v1 = x2 * c4 + x1 * s4;
                        u32x4 w; w.x = cvt_pk_bf16(v0[0], v0[1]); w.y = cvt_pk_bf16(v0[2], v0[3]); w.z = cvt_pk_bf16(v1[0], v1[1]); w.w = cvt_pk_bf16(v1[2], v1[3]);
                        *(u32x4*)(rowp + bj * HALF) = w; } }
        } else if (wc < 3) {
            const bool idx = (wc == 0) && (fq < 2);
            const int col0 = wc * 32 + 8 * fq;
#pragma unroll
            for (int ai = 0; ai < 2; ++ai)
#pragma unroll
                for (int m = 0; m < 4; ++m) { const int row = row0 + ai * HALF + m * 16;
                    f32x4 c4 = (f32x4){1.f, 1.f, 1.f, 1.f}, s4 = (f32x4){0.f, 0.f, 0.f, 0.f};
                    if (idx) { c4 = *(const f32x4*)(CI + (size_t)row * 8 + 4 * fq); s4 = *(const f32x4*)(SI + (size_t)row * 8 + 4 * fq); }
                    const f32x4 x1 = acc[ai][0][m][0], x2 = acc[ai][0][m][1];
                    const f32x4 v0 = x1 * c4 - x2 * s4, v1 = x2 * c4 + x1 * s4;
                    float* sp = SM + (size_t)row * 128 + col0; *(f32x4*)sp = v0; *(f32x4*)(sp + 4) = v1;
                    if (wc < 2) { u32x4 w; w.x = cvt_pk_bf16(v0[0], v0[1]); w.y = cvt_pk_bf16(v0[2], v0[3]); w.z = cvt_pk_bf16(v1[0], v1[1]); w.w = cvt_pk_bf16(v1[2], v1[3]);
                        *(u32x4*)(IKB + (size_t)row * 64 + col0) = w; } }
        }
    }
};

template <class Epi, class Sched, bool ALIGN_EPI = false, bool SP2 = false>
__device__ __forceinline__ void gemm_phase(PG8_LAS unsigned char* lds, const Gemm g, const Sched& S, const Epi& E) {
    int tid_ = threadIdx.x; asm volatile("" : "+v"(tid_));
    const int tid = tid_, wid = __builtin_amdgcn_readfirstlane(tid >> 6), lane = tid & 63, wr = wid >> 2, wc = wid & 3, fr = lane & 15, fq = lane >> 4;
    const int K = g.K, nt = K / BK;
    unsigned voffA[2], voffB[2];
#pragma unroll
    for (int i = 0; i < 2; ++i) { int R, C; stage_rc(tid * 16 + i * 8192, R, C); const int Rb = Epi::PERM ? ((R & ~31) + perm32(R & 31)) : R;
        voffA[i] = (unsigned)(R * g.lda + C) * 2u; voffB[i] = (unsigned)(Rb * K + C) * 2u; }
    const size_t kstep = (size_t)(BK * 2);
    const size_t hstep = (size_t)HALF * K * 2;
    const size_t tstep = 2 * hstep; const size_t hstepA = (size_t)HALF * g.lda * 2, tstepA = 2 * hstepA;
    const unsigned ldsw = (unsigned)wid * 1024u;
    const int aoff = lds_byte(wr * 64 + fr, fq * 8), boff = lds_byte(wc * 32 + fr, fq * 8);
#define PG8_SA(b, h) (((b) * 2 + (h)) * HTB)
#define PG8_SB(b, h) ((4 + (b) * 2 + (h)) * HTB)
#define PG8_STAGE(bufoff, gbase, voff) do { _Pragma("unroll") for (int _i = 0; _i < 2; ++_i) \
        __builtin_amdgcn_global_load_lds((const unsigned*)((const char*)(gbase) + (voff)[_i]), (PG8_LAS unsigned*)(lds + (bufoff) + ldsw + _i * 8192), 16, 0, 0); } while (0)
#define PG8_LDA(dst, b, h) do { _Pragma("unroll") for (int m = 0; m < 4; ++m) _Pragma("unroll") for (int k = 0; k < 2; ++k) dst[m][k] = *(const PG8_LAS bf16x8*)(lds + PG8_SA(b, h) + aoff + m * 2048 + k * 1024); } while (0)
#define PG8_LDB(dst, b, h) do { _Pragma("unroll") for (int n = 0; n < 2; ++n) _Pragma("unroll") for (int k = 0; k < 2; ++k) dst[n][k] = *(const PG8_LAS bf16x8*)(lds + PG8_SB(b, h) + boff + n * 2048 + k * 1024); } while (0)
#define PG8_MMA(ai, bj, At, Bt) do { __builtin_amdgcn_s_setprio(1); _Pragma("unroll") for (int m = 0; m < 4; ++m) _Pragma("unroll") for (int n = 0; n < 2; ++n) _Pragma("unroll") for (int k = 0; k < 2; ++k) \
        acc[ai][bj][m][n] = __builtin_amdgcn_mfma_f32_16x16x32_bf16(Bt[n][k], At[m][k], acc[ai][bj][m][n], 0, 0, 0); __builtin_amdgcn_s_setprio(0); } while (0)
#define PG8_WAIT_V(n) asm volatile("s_waitcnt vmcnt(" #n ")" ::: "memory")
#define PG8_WAIT_L(n) asm volatile("s_waitcnt lgkmcnt(" #n ")" ::: "memory")
#define PG8_BAR __builtin_amdgcn_s_barrier()
#define PG8_SCHED __builtin_amdgcn_sched_barrier(0)
    Unit cur, nxt; int ui = 0;
    if (!S.next(0, cur)) return;
    f32x4 acc[2][2][4][2];
#pragma unroll
    for (int a = 0; a < 2; ++a)
#pragma unroll
        for (int b = 0; b < 2; ++b)
#pragma unroll
            for (int m = 0; m < 4; ++m)
#pragma unroll
                for (int n = 0; n < 2; ++n) acc[a][b][m][n] = (f32x4){0.f, 0.f, 0.f, 0.f};
    bf16x8 At[4][2], B0[2][2], B1[2][2];
    const char* cA = (const char*)g.A + (size_t)cur.pm * tstepA; const char* cB = (const char*)g.Bt + (size_t)cur.pn * tstep;
    S.a_ready(cur);
    if constexpr (SP2) {
        PG8_STAGE(PG8_SB(0, 0), cB, voffB); PG8_STAGE(PG8_SB(0, 1), cB + hstep, voffB); PG8_STAGE(PG8_SA(0, 0), cA, voffA); PG8_STAGE(PG8_SA(0, 1), cA + hstepA, voffA);
        if (wr == 1) PG8_BAR;
        PG8_WAIT_V(2); PG8_BAR;
        PG8_STAGE(PG8_SB(1, 0), cB + kstep, voffB); PG8_STAGE(PG8_SA(1, 0), cA + kstep, voffA); PG8_STAGE(PG8_SB(1, 1), cB + hstep + kstep, voffB);
        PG8_WAIT_V(6); PG8_BAR;
    } else {
        PG8_STAGE(PG8_SB(0, 0), cB, voffB); PG8_STAGE(PG8_SA(0, 0), cA, voffA); PG8_STAGE(PG8_SB(0, 1), cB + hstep, voffB); PG8_STAGE(PG8_SA(0, 1), cA + hstepA, voffA);
        if (wr == 1) PG8_BAR;
        PG8_WAIT_V(4); PG8_BAR;
        PG8_STAGE(PG8_SB(1, 0), cB + kstep, voffB); PG8_STAGE(PG8_SA(1, 0), cA + kstep, voffA); PG8_STAGE(PG8_SB(1, 1), cB + hstep + kstep, voffB);
        PG8_WAIT_V(6); PG8_BAR;
    }
    for (;;) {
        const bool has_next = S.next(ui + 1, nxt);
        const char* nA = has_next ? (const char*)g.A + (size_t)nxt.pm * tstepA : cA; const char* nB = has_next ? (const char*)g.Bt + (size_t)nxt.pn * tstep : cB;
        for (int t = 0; t < nt; t += 2) {
            const bool last = (t == nt - 2);
            const char* a1 = cA + (size_t)(t + 1) * kstep;
            const char* a2 = last ? nA : cA + (size_t)(t + 2) * kstep; const char* b2 = last ? nB : cB + (size_t)(t + 2) * kstep;
            const char* a3 = a2 + kstep; const char* b3 = b2 + kstep;
            if (last && has_next) S.a_ready(nxt);
            if constexpr (SP2) {
            PG8_LDB(B0, 0, 0); PG8_LDB(B1, 0, 1); PG8_SCHED; PG8_LDA(At, 0, 0); PG8_STAGE(PG8_SA(1, 1), a1 + hstepA, voffA);
            PG8_WAIT_V(8); PG8_WAIT_L(0); PG8_BAR; PG8_MMA(0, 0, At, B0); PG8_MMA(0, 1, At, B1); PG8_BAR; PG8_SCHED;
            PG8_LDA(At, 0, 1); PG8_STAGE(PG8_SB(0, 0), b2, voffB); PG8_STAGE(PG8_SB(0, 1), b2 + hstep, voffB); PG8_STAGE(PG8_SA(0, 0), a2, voffA);
            PG8_WAIT_V(8); PG8_WAIT_L(0); PG8_BAR; PG8_MMA(1, 0, At, B0); PG8_MMA(1, 1, At, B1); PG8_BAR; PG8_SCHED;
            PG8_LDB(B0, 1, 0); PG8_LDB(B1, 1, 1); PG8_SCHED; PG8_LDA(At, 1, 0); PG8_STAGE(PG8_SA(0, 1), a2 + hstepA, voffA);
            PG8_WAIT_V(8); PG8_WAIT_L(0); PG8_BAR; PG8_MMA(0, 0, At, B0); PG8_MMA(0, 1, At, B1); PG8_BAR; PG8_SCHED;
            PG8_LDA(At, 1, 1); PG8_STAGE(PG8_SB(1, 0), b3, voffB); PG8_STAGE(PG8_SB(1, 1), b3 + hstep, voffB); PG8_STAGE(PG8_SA(1, 0), a3, voffA);
            PG8_WAIT_V(8); PG8_WAIT_L(0); PG8_BAR; PG8_MMA(1, 0, At, B0); PG8_MMA(1, 1, At, B1); PG8_BAR; PG8_SCHED;
            } else {
            PG8_LDB(B0, 0, 0); PG8_SCHED; PG8_LDA(At, 0, 0); PG8_STAGE(PG8_SA(1, 1), a1 + hstepA, voffA);
            PG8_WAIT_L(8); PG8_BAR; PG8_WAIT_L(0); PG8_MMA(0, 0, At, B0); PG8_BAR; PG8_SCHED;
            PG8_LDB(B1, 0, 1); PG8_STAGE(PG8_SB(0, 0), b2, voffB);
            PG8_BAR; PG8_WAIT_L(0); PG8_MMA(0, 1, At, B1); PG8_BAR;
            PG8_LDA(At, 0, 1); PG8_STAGE(PG8_SA(0, 0), a2, voffA);
            PG8_BAR; PG8_WAIT_L(0); PG8_MMA(1, 0, At, B0); PG8_BAR; PG8_SCHED;
            PG8_STAGE(PG8_SB(0, 1), b2 + hstep, voffB);
            PG8_WAIT_V(6); PG8_BAR; PG8_MMA(1, 1, At, B1); PG8_BAR;
            PG8_LDB(B0, 1, 0); PG8_SCHED; PG8_LDA(At, 1, 0); PG8_STAGE(PG8_SA(0, 1), a2 + hstepA, voffA);
            PG8_WAIT_L(8); PG8_BAR; PG8_WAIT_L(0); PG8_MMA(0, 0, At, B0); PG8_BAR; PG8_SCHED;
            PG8_LDB(B1, 1, 1); PG8_STAGE(PG8_SB(1, 0), b3, voffB);
            PG8_BAR; PG8_WAIT_L(0); PG8_MMA(0, 1, At, B1); PG8_BAR;
            PG8_LDA(At, 1, 1); PG8_STAGE(PG8_SA(1, 0), a3, voffA);
            PG8_BAR; PG8_WAIT_L(0); PG8_MMA(1, 0, At, B0); PG8_BAR; PG8_SCHED;
            PG8_STAGE(PG8_SB(1, 1), b3 + hstep, voffB);
            PG8_WAIT_V(6); PG8_BAR; PG8_MMA(1, 1, At, B1); PG8_BAR;
            }
        }
        if constexpr (ALIGN_EPI) { if (wr == 0) PG8_BAR; }
        if constexpr (!Epi::AFTER_DRAIN) { E(acc, cur, wr, wc, fr, fq); S.done(cur); }
        if (!has_next) break;
#pragma unroll
        for (int a = 0; a < 2; ++a)
#pragma unroll
            for (int b = 0; b < 2; ++b)
#pragma unroll
                for (int m = 0; m < 4; ++m)
#pragma unroll
                    for (int n = 0; n < 2; ++n) acc[a][b][m][n] = (f32x4){0.f, 0.f, 0.f, 0.f};
        cur = nxt; cA = nA; cB = nB; ++ui;
        if constexpr (ALIGN_EPI) { if (wr == 1) PG8_BAR; }
    }
    PG8_WAIT_V(0);
    if constexpr (!ALIGN_EPI) { if (wr == 0) PG8_BAR; }
    PG8_BAR;
    if constexpr (Epi::AFTER_DRAIN) { E.fused(acc, cur, wr, wc, fr, fq, lds, wid, lane); S.done(cur); }
#undef PG8_SA
#undef PG8_SB
#undef PG8_STAGE
#undef PG8_LDA
#undef PG8_LDB
#undef PG8_MMA
#undef PG8_WAIT_V
#undef PG8_WAIT_L
#undef PG8_BAR
#undef PG8_SCHED
}
}
#define GAS __attribute__((address_space(1)))
#define LAS __attribute__((address_space(3)))
typedef unsigned short bf16;
typedef unsigned v4u __attribute__((ext_vector_type(4)));
typedef float f32x4 __attribute__((ext_vector_type(4)));
typedef short bf16x8 __attribute__((ext_vector_type(8)));
typedef GAS unsigned gu32;
typedef GAS unsigned long long gu64;
#define RLX_AGENT __ATOMIC_RELAXED, __HIP_MEMORY_SCOPE_AGENT
#define LDS_WAIT() asm volatile("s_waitcnt lgkmcnt(0)" ::: "memory")
#define VM_WAIT() asm volatile("s_waitcnt vmcnt(0)" ::: "memory")
__device__ __forceinline__ unsigned long long rt() { return __builtin_amdgcn_s_memrealtime(); }
__device__ __forceinline__ unsigned f2bf(float f) { unsigned u = __builtin_bit_cast(unsigned, f); return (u + 0x7fffu + ((u >> 16) & 1u)) >> 16; }
__device__ __forceinline__ unsigned pk2(float lo, float hi) { return f2bf(lo) | (f2bf(hi) << 16); }

#define XB_TMO      128
#define XB_XCNT(j)  (256  + 64 * (j))
#define XB_XSUB(j)  (1280 + 64 * (j))
#define XB_XGEN(j)  (2304 + 64 * (j))
#define XB_TOP      3328
#define XB_TOPGEN   3392
#define XCD_BAR_WORDS 3456
#define XB_SPIN_CAP (1u << 18)

__device__ __forceinline__ unsigned xb_ld(unsigned* p)              { return __hip_atomic_load(p, __ATOMIC_RELAXED, __HIP_MEMORY_SCOPE_AGENT); }
__device__ __forceinline__ unsigned xb_add(unsigned* p, unsigned v) { return __hip_atomic_fetch_add(p, v, __ATOMIC_RELAXED, __HIP_MEMORY_SCOPE_AGENT); }
__device__ __forceinline__ unsigned xb_xcc_id() { return (unsigned)__builtin_amdgcn_s_getreg((3 << 11) | 20) & 0xFu; }
#define XB_SPIN(cond, bar) do { unsigned _sp = 0; while (cond) { __builtin_amdgcn_s_sleep(1); \
    if ((++_sp & 255u) == 0u) { if (xb_ld(&(bar)[XB_TMO])) break; if (_sp > XB_SPIN_CAP) { atomicAdd(&(bar)[XB_TMO], 1u); break; } } } } while (0)

struct XcdBarrier {
    unsigned* bar; unsigned x;
    volatile LAS unsigned* st;
};

__device__ __forceinline__ XcdBarrier xcd_barrier_post(unsigned* bar, volatile LAS unsigned* st) {
    XcdBarrier b; b.bar = bar; b.x = xb_xcc_id(); b.st = st;
    if (threadIdx.x == 0) (void)xb_add(&bar[XB_XCNT(b.x)], 1u);
    return b;
}
__device__ __forceinline__ void xcd_barrier_complete(unsigned* bar, unsigned x, unsigned& nloc, unsigned& nx) {
    const unsigned G = gridDim.x * gridDim.y * gridDim.z;
    unsigned sum, cnt, mine, sp = 0u;
    for (;;) {
        sum = 0u; cnt = 0u; mine = 0u;
#pragma unroll
        for (unsigned j = 0; j < 16; ++j) { const unsigned c = xb_ld(&bar[XB_XCNT(j)]); sum += c; cnt += (c > 0u) ? 1u : 0u; mine = (j == x) ? c : mine; }
        if (sum == G) break;
        __builtin_amdgcn_s_sleep(1);
        if ((++sp & 255u) == 0u) { if (xb_ld(&bar[XB_TMO])) break; if (sp > XB_SPIN_CAP) { atomicAdd(&bar[XB_TMO], 1u); break; } }
    }
    nloc = mine > 0u ? mine : 1u; nx = cnt > 0u ? cnt : 1u;
}

__device__ __forceinline__ void xcd_barrier(const XcdBarrier& b) {
    asm volatile("s_waitcnt vmcnt(0)" ::: "memory");
    __syncthreads();
    if (threadIdx.x == 0) {
        unsigned* bar = b.bar;
        __builtin_amdgcn_s_waitcnt(0);
        unsigned nloc = b.st[0], nx = b.st[1];
        if (nloc == 0u) { xcd_barrier_complete(bar, b.x, nloc, nx); b.st[0] = nloc; b.st[1] = nx; }
        const unsigned old = xb_add(&bar[XB_XSUB(b.x)], 1u);
        const unsigned gen = old / nloc;
        if (old + 1u == (gen + 1u) * nloc) {
            __builtin_amdgcn_fence(__ATOMIC_RELEASE, "agent");
            asm volatile("s_waitcnt vmcnt(0)" ::: "memory");
            const unsigned og = xb_add(&bar[XB_TOP], 1u);
            const unsigned tg = og / nx;
            if (og + 1u == (tg + 1u) * nx) xb_add(&bar[XB_TOPGEN], 1u);
            else XB_SPIN(xb_ld(&bar[XB_TOPGEN]) == tg, bar);
            __builtin_amdgcn_fence(__ATOMIC_ACQUIRE, "agent");
            xb_add(&bar[XB_XGEN(b.x)], 1u);
            asm volatile("s_waitcnt vmcnt(0)" ::: "memory");
        } else {
            XB_SPIN(xb_ld(&bar[XB_XGEN(b.x)]) == gen, bar);
            __builtin_amdgcn_fence(__ATOMIC_ACQUIRE, "agent");
            asm volatile("s_waitcnt vmcnt(0)" ::: "memory");
        }
    }
    __syncthreads();
}

constexpr int BATCH = 4, SEQ = 4096, DM = 2048, M = BATCH * SEQ, DEPTH = 2, D_IN = 7264, NPROJ = 7168, NIN = 7424, DFF = 8192;
constexpr int PITCH = NPROJ;
constexpr int PC_GQ = 0, PC_GK = 512, PC_GV = 1024, PC_GG = 2048, PC_DQ = 3072, PC_DK = 4096, PC_DV = 5120, PC_IQ = 6144;
constexpr int PC_O = 2048;
constexpr int PC_MX = 4096;
constexpr float EPS = 1e-6f;
constexpr int NWAVES = 8, NTHREADS = 512;
constexpr int NPHASE = 1 + 9 * DEPTH;

constexpr size_t MiB = 1u << 20;
constexpr size_t WS_CTL = 0, CTL_ZERO_BYTES = 1 * MiB;
constexpr size_t WS_CA = 1 * MiB, WS_SA = 2 * MiB, WS_CI = 3 * MiB, WS_SI = 3 * MiB + 512 * 1024;
constexpr size_t WS_SM = 4 * MiB;
constexpr size_t WS_IKB = 12 * MiB;
constexpr size_t WS_DEC = 14 * MiB;
constexpr size_t WS_MASK = 16 * MiB;
constexpr size_t WS_WIN = 24 * MiB;
constexpr size_t WS_WOUT = 53 * MiB;
constexpr size_t WS_AREG = 61 * MiB;
constexpr size_t WS_PROJ = 125 * MiB;
constexpr size_t WS_SC = 381 * MiB;
constexpr size_t WS_WUP = 381 * MiB, WS_WDN = 413 * MiB;
constexpr size_t WS_END = 511 * MiB;
constexpr int CW_BAR = 4096;

constexpr int RING_BYTES = 131072, LDSCTL_OFF = RING_BYTES, MISC_OFF = LDSCTL_OFF + 320, LDS_BYTES = 147456;

struct Frame {
    LAS unsigned char* lds; volatile LAS unsigned* MISC; gu32* ctl;
    int tid, lane, wave, vcu, G;
    unsigned char* ws;
    const float* x; const int* pos; const float* g_pre; const float* w_in; const float* wa2; const float* ba; const float* gnorm; const float* w_out;
    const float* g_post; const float* g_fpre; const float* w_up; const float* w_down; const float* g_fpost; float* out;
};

__device__ __forceinline__ float wave_sum(float v) {
#pragma unroll
    for (int o = 1; o < 64; o <<= 1) v += __shfl_xor(v, o);
    return v;
}
__device__ __forceinline__ float bf2f(unsigned v) { return __uint_as_float(v << 16); }
__device__ __forceinline__ float bflo(unsigned w) { return __uint_as_float(w << 16); }
__device__ __forceinline__ float bfhi(unsigned w) { return __uint_as_float(w & 0xffff0000u); }
typedef unsigned u32x2 __attribute__((ext_vector_type(2)));
typedef float f32x16 __attribute__((ext_vector_type(16)));

__device__ __forceinline__ int perm_dsa(int x) { const int hd = x >> 7, p = x & 127; const int d = (p < 32) ? (16 * ((p >> 2) & 1) + 4 * (p >> 3) + (p & 3)) : p; return hd * 128 + d; }
__device__ __forceinline__ int perm_idx(int x) { const int hd = x >> 6, p = x & 63; const int d = (p < 16) ? (8 * ((p >> 2) & 1) + 4 * (p >> 3) + (p & 3)) : p; return hd * 64 + d; }
__device__ __forceinline__ int win_src(int n) {
    if (n < 3072) return n;
    if (n < 4096) return 3088 + perm_dsa(n - 3072);
    if (n < 5120) return 4112 + perm_dsa(n - 4096);
    if (n < 6144) return 5136 + (n - 5120);
    if (n < 7168) return 6160 + perm_idx(n - 6144);
    const int p = n - 7168;
    if (p < 64) return 7184 + perm_idx(p);
    if (p < 80) return 3072 + (p - 64);
    if (p < 96) return 7248 + (p - 80);
    return -1;
}
template <int MODE> __device__ __forceinline__ void transpose_item(const float* W, int K, int N, bf16* WT, LAS float* scr, int item, int nblk, int lane) {
    const int kb = item / nblk, nb = item % nblk, k0 = 64 * kb, n0 = 32 * nb;
    int src = n0 + (lane & 31); float keep = 1.f;
    if (MODE) { src = win_src(src); if (src < 0) { src = 0; keep = 0.f; } }
#pragma unroll 8
    for (int i = 0; i < 32; ++i) { const int kk = 2 * i + (lane >> 5); scr[kk * 33 + (lane & 31)] = W[(size_t)(k0 + kk) * N + src] * keep; }
    LDS_WAIT(); asm volatile("" ::: "memory");
    const int c = lane & 7;
#pragma unroll
    for (int j = 0; j < 4; ++j) { const int n = (lane >> 3) + 8 * j; const LAS float* s = scr + (8 * c) * 33 + n;
        v4u o; o.x = pk2(s[0 * 33], s[1 * 33]); o.y = pk2(s[2 * 33], s[3 * 33]); o.z = pk2(s[4 * 33], s[5 * 33]); o.w = pk2(s[6 * 33], s[7 * 33]);
        *(GAS v4u*)(WT + (size_t)(n0 + n) * K + k0 + 8 * c) = o; }
    LDS_WAIT(); asm volatile("" ::: "memory");
}
__device__ __forceinline__ void convert_weights(Frame& F, int l, int which) {
    LAS float* scr = (LAS float*)(F.lds + F.wave * 16384);
    const int gw = F.vcu * NWAVES + F.wave, NGW = F.G * NWAVES;
    if (which == 0) {
        const float* wi = F.w_in + (size_t)l * DM * D_IN; const float* wo = F.w_out + (size_t)l * DM * DM;
        constexpr int I_IN = (DM / 64) * (NIN / 32), I_O = (DM / 64) * (DM / 32);
        for (int it = gw; it < I_IN + I_O; it += NGW) {
            if (it < I_IN) transpose_item<1>(wi, DM, D_IN, (bf16*)(F.ws + WS_WIN), scr, it, NIN / 32, F.lane);
            else transpose_item<0>(wo, DM, DM, (bf16*)(F.ws + WS_WOUT), scr, it - I_IN, DM / 32, F.lane);
        }
    } else {
        const float* wu = F.w_up + (size_t)l * DM * DFF; const float* wd = F.w_down + (size_t)l * DFF * DM;
        constexpr int I_U = (DM / 64) * (DFF / 32), I_D = (DFF / 64) * (DM / 32);
        for (int it = gw; it < I_U + I_D; it += NGW) {
            if (it < I_U) transpose_item<0>(wu, DM, DFF, (bf16*)(F.ws + WS_WUP), scr, it, DFF / 32, F.lane);
            else transpose_item<0>(wd, DFF, DM, (bf16*)(F.ws + WS_WDN), scr, it - I_U, DM / 32, F.lane);
        }
    }
}

__device__ __forceinline__ void sincos_cw(float x, float& s, float& c) {
    const float k = rintf(x * 0.6366197723675814f);
    float r = fmaf(-k, 1.5703125f, x); r = fmaf(-k, 4.837512969970703125e-4f, r); r = fmaf(-k, 7.54978995489188216e-8f, r);
    const float r2 = r * r;
    const float sr = fmaf(r * r2, fmaf(r2, fmaf(r2, -1.9515295891e-4f, 8.3321608736e-3f), -1.6666654611e-1f), r);
    const float cr = fmaf(r2 * r2, fmaf(r2, fmaf(r2, 2.443315711809948e-5f, -1.388731625493765e-3f), 4.166664568298827e-2f), fmaf(-0.5f, r2, 1.0f));
    const int q = ((int)k) & 3;
    s = (q == 0) ? sr : (q == 1) ? cr : (q == 2) ? -sr : -cr;
    c = (q == 0) ? cr : (q == 1) ? -sr : (q == 2) ? -cr : sr;
}
__device__ __forceinline__ void rope_tables(Frame& F) {
    float* CA = (float*)(F.ws + WS_CA); float* SA = (float*)(F.ws + WS_SA); float* CI = (float*)(F.ws + WS_CI); float* SI = (float*)(F.ws + WS_SI);
    for (int idx = F.vcu * NTHREADS + F.tid; idx < M * 24; idx += F.G * NTHREADS) {
        const int m = idx / 24, i = idx - m * 24; const float p = (float)F.pos[m];
        float s, c;
        if (i < 16) { const float inv = exp2f(-(float)i * (18.931568569324174f / 16.f)); sincos_cw(p * inv, s, c); CA[m * 16 + i] = c; SA[m * 16 + i] = s; }
        else { const int j = i - 16; const float inv = exp2f(-(float)j * (18.931568569324174f / 8.f)); sincos_cw(p * inv, s, c); CI[m * 8 + j] = c; SI[m * 8 + j] = s; }
    }
}

__device__ __forceinline__ void norm_row_to_bf16(const float* xrow, const float* g, bf16* orow, int lane) {
    f32x4 v[8]; float ss = 0.f;
#pragma unroll
    for (int c = 0; c < 4; ++c) { v[2 * c] = *(const GAS f32x4*)(xrow + 512 * c + 8 * lane); v[2 * c + 1] = *(const GAS f32x4*)(xrow + 512 * c + 8 * lane + 4); }
#pragma unroll
    for (int j = 0; j < 8; ++j) ss += (v[j].x * v[j].x + v[j].y * v[j].y) + (v[j].z * v[j].z + v[j].w * v[j].w);
    const float rs = 1.0f / sqrtf(wave_sum(ss) * (1.f / DM) + EPS);
#pragma unroll
    for (int c = 0; c < 4; ++c) { const f32x4 g0 = *(const GAS f32x4*)(g + 512 * c + 8 * lane), g1 = *(const GAS f32x4*)(g + 512 * c + 8 * lane + 4);
        const f32x4 a = v[2 * c] * rs * g0, b = v[2 * c + 1] * rs * g1;
        v4u o; o.x = pk2(a.x, a.y); o.y = pk2(a.z, a.w); o.z = pk2(b.x, b.y); o.w = pk2(b.z, b.w);
        *(GAS v4u*)(orow + 512 * c + 8 * lane) = o; }
}
__device__ __forceinline__ void residual_row(const bf16* srow, const float* hbase, const float* gp, float* hout, const float* gn, bf16* arow, bool write_a, int lane) {
    f32x4 v[8]; float ss = 0.f;
#pragma unroll
    for (int c = 0; c < 4; ++c) { const v4u w = *(const GAS v4u*)(srow + 512 * c + 8 * lane);
        v[2 * c] = (f32x4){bflo(w.x), bfhi(w.x), bflo(w.y), bfhi(w.y)}; v[2 * c + 1] = (f32x4){bflo(w.z), bfhi(w.z), bflo(w.w), bfhi(w.w)}; }
#pragma unroll
    for (int j = 0; j < 8; ++j) ss += (v[j].x * v[j].x + v[j].y * v[j].y) + (v[j].z * v[j].z + v[j].w * v[j].w);
    const float rs = 1.0f / sqrtf(wave_sum(ss) * (1.f / DM) + EPS);
    float s2 = 0.f;
#pragma unroll
    for (int c = 0; c < 4; ++c)
#pragma unroll
        for (int q = 0; q < 2; ++q) { const int off = 512 * c + 8 * lane + 4 * q;
            const f32x4 hb = *(const GAS f32x4*)(hbase + off), g0 = *(const GAS f32x4*)(gp + off);
            const f32x4 hn = hb + v[2 * c + q] * rs * g0; v[2 * c + q] = hn; *(GAS f32x4*)(hout + off) = hn;
            s2 += (hn.x * hn.x + hn.y * hn.y) + (hn.z * hn.z + hn.w * hn.w); }
    if (write_a) {
        const float r2 = 1.0f / sqrtf(wave_sum(s2) * (1.f / DM) + EPS);
#pragma unroll
        for (int c = 0; c < 4; ++c) { const f32x4 g0 = *(const GAS f32x4*)(gn + 512 * c + 8 * lane), g1 = *(const GAS f32x4*)(gn + 512 * c + 8 * lane + 4);
            const f32x4 a = v[2 * c] * r2 * g0, b = v[2 * c + 1] * r2 * g1;
            v4u o; o.x = pk2(a.x, a.y); o.y = pk2(a.z, a.w); o.z = pk2(b.x, b.y); o.w = pk2(b.z, b.w);
            *(GAS v4u*)(arow + 512 * c + 8 * lane) = o; }
    }
}

__device__ __forceinline__ void gla_gate(LAS unsigned char* lds, const float* SM, const float* wa2l, const float* bal, int row0, int h, int tid, float (&bb)[16], float& blast) {
    LAS float* GR = (LAS float*)lds; LAS float* WA = (LAS float*)(lds + 4096); LAS float* TOT = (LAS float*)(lds + 12288);
    const int d = tid & 127, g = tid >> 7;
    __syncthreads();
    if (tid < 256) { const int r = tid >> 2, c4 = tid & 3; *(LAS f32x4*)(GR + r * 16 + 4 * c4) = *(const GAS f32x4*)(SM + (size_t)(row0 + r) * 128 + 64 + 4 * c4); }
    { const int r = tid >> 5, c = (tid & 31) * 4; *(LAS f32x4*)(WA + r * 128 + c) = *(const GAS f32x4*)(wa2l + r * 512 + h * 128 + c); }
    const float bad = bal[h * 128 + d];
    __syncthreads();
    float wcol[16];
#pragma unroll
    for (int r = 0; r < 16; ++r) wcol[r] = WA[r * 128 + d];
    float run = 0.f;
#pragma unroll
    for (int i = 0; i < 16; ++i) { const int j = 16 * g + i; float z = bad;
#pragma unroll
        for (int r4 = 0; r4 < 4; ++r4) { const f32x4 gv = *(const LAS f32x4*)(GR + j * 16 + 4 * r4); z += gv.x * wcol[4 * r4] + gv.y * wcol[4 * r4 + 1] + gv.z * wcol[4 * r4 + 2] + gv.w * wcol[4 * r4 + 3]; }
        const float la = (fminf(z, 0.f) - __logf(1.f + __expf(-fabsf(z)))) * (1.f / 16.f);
        run += la; bb[i] = run; }
    TOT[g * 128 + d] = run;
    __syncthreads();
    float pre = 0.f, tot = 0.f;
#pragma unroll
    for (int gg = 0; gg < 4; ++gg) { const float t = TOT[gg * 128 + d]; pre += (gg < g) ? t : 0.f; tot += t; }
#pragma unroll
    for (int i = 0; i < 16; ++i) bb[i] += pre;
    blast = tot;
}
__device__ __forceinline__ void stage_vt(LAS unsigned char* VT, const bf16* P, int row0, int vcol, int tid) {
    const int e = tid & 255, jh = tid >> 8; unsigned pk[16];
#pragma unroll
    for (int i = 0; i < 16; ++i) { const unsigned a = P[(size_t)(row0 + 32 * jh + 2 * i) * PITCH + vcol + e], b = P[(size_t)(row0 + 32 * jh + 2 * i + 1) * PITCH + vcol + e]; pk[i] = a | (b << 16); }
#pragma unroll
    for (int q = 0; q < 4; ++q) *(LAS v4u*)(VT + e * 144 + 64 * jh + 16 * q) = (v4u){pk[4 * q], pk[4 * q + 1], pk[4 * q + 2], pk[4 * q + 3]};
}
__device__ __forceinline__ void ph_gla_local(Frame& F, int l) {
    LAS unsigned char* lds = F.lds; int tid_ = F.tid; asm volatile("" : "+v"(tid_)); const int tid = tid_, lane = tid & 63, w = __builtin_amdgcn_readfirstlane(tid >> 6);
    LAS unsigned char* KDT = lds + 16384; LAS unsigned char* VT = lds + 34816;
    const bf16* P = (const bf16*)(F.ws + WS_PROJ); const float* SM = (const float*)(F.ws + WS_SM);
    float* DEC = (float*)(F.ws + WS_DEC); bf16* DS = (bf16*)(F.ws + WS_AREG);
    const float* wa2l = F.wa2 + (size_t)l * 16 * 512; const float* bal = F.ba + (size_t)l * 512;
    const int fr = lane & 15, fq = lane >> 4;
    for (int u = F.vcu; u < 1024; u += F.G) {
        const int bh = u >> 6, n = u & 63, b = bh >> 2, h = bh & 3, row0 = b * SEQ + n * 64;
        float bb[16]; float blast;
        gla_gate(lds, SM, wa2l, bal, row0, h, tid, bb, blast);
        const int d = tid & 127, g = tid >> 7;
        { unsigned pk[8];
#pragma unroll
          for (int i = 0; i < 8; ++i) { const float k0 = bf2f(P[(size_t)(row0 + 16 * g + 2 * i) * PITCH + PC_GK + h * 128 + d]) * __expf(blast - bb[2 * i]);
              const float k1 = bf2f(P[(size_t)(row0 + 16 * g + 2 * i + 1) * PITCH + PC_GK + h * 128 + d]) * __expf(blast - bb[2 * i + 1]); pk[i] = pk2(k0, k1); }
          *(LAS v4u*)(KDT + d * 144 + 32 * g) = (v4u){pk[0], pk[1], pk[2], pk[3]}; *(LAS v4u*)(KDT + d * 144 + 32 * g + 16) = (v4u){pk[4], pk[5], pk[6], pk[7]}; }
        if (g == 0) DEC[(size_t)(bh * 64 + n) * 128 + d] = __expf(blast);
        stage_vt(VT, P, row0, PC_GV + h * 256, tid);
        __syncthreads();
        f32x4 acc[8][2];
#pragma unroll
        for (int dt = 0; dt < 8; ++dt) { acc[dt][0] = (f32x4){0.f, 0.f, 0.f, 0.f}; acc[dt][1] = (f32x4){0.f, 0.f, 0.f, 0.f}; }
#pragma unroll
        for (int s = 0; s < 2; ++s) { bf16x8 bv[2];
#pragma unroll
            for (int t = 0; t < 2; ++t) bv[t] = *(const LAS bf16x8*)(VT + ((2 * w + t) * 16 + fr) * 144 + (8 * fq + 32 * s) * 2);
#pragma unroll
            for (int dt = 0; dt < 8; ++dt) { const bf16x8 ak = *(const LAS bf16x8*)(KDT + (16 * dt + fr) * 144 + (8 * fq + 32 * s) * 2);
                acc[dt][0] = __builtin_amdgcn_mfma_f32_16x16x32_bf16(ak, bv[0], acc[dt][0], 0, 0, 0); acc[dt][1] = __builtin_amdgcn_mfma_f32_16x16x32_bf16(ak, bv[1], acc[dt][1], 0, 0, 0); } }
#pragma unroll
        for (int dt = 0; dt < 8; ++dt)
#pragma unroll
            for (int t = 0; t < 2; ++t) { const int e = (2 * w + t) * 16 + fr; const f32x4 a = acc[dt][t];
                *(GAS u32x2*)(DS + ((size_t)(bh * 64 + n) * 256 + e) * 128 + 16 * dt + 4 * fq) = (u32x2){pk2(a.x, a.y), pk2(a.z, a.w)}; }
    }
}
__device__ __forceinline__ void ph_gla_scan(Frame& F) {
    const float* DEC = (const float*)(F.ws + WS_DEC); bf16* DS = (bf16*)(F.ws + WS_AREG);
    for (int gid = F.vcu * NTHREADS + F.tid; gid < 16 * 256 * 32; gid += F.G * NTHREADS) {
        const int bh = gid >> 13, e = (gid >> 5) & 255, d4 = gid & 31;
        f32x4 S = (f32x4){0.f, 0.f, 0.f, 0.f};
        for (int nb = 0; nb < 64; nb += 8) {
            u32x2 x[8]; f32x4 dc[8];
#pragma unroll
            for (int k = 0; k < 8; ++k) { x[k] = *(const GAS u32x2*)(DS + ((size_t)(bh * 64 + nb + k) * 256 + e) * 128 + 4 * d4); dc[k] = *(const GAS f32x4*)(DEC + (size_t)(bh * 64 + nb + k) * 128 + 4 * d4); }
#pragma unroll
            for (int k = 0; k < 8; ++k) { *(GAS u32x2*)(DS + ((size_t)(bh * 64 + nb + k) * 256 + e) * 128 + 4 * d4) = (u32x2){pk2(S.x, S.y), pk2(S.z, S.w)};
                S = dc[k] * S + (f32x4){bflo(x[k].x), bfhi(x[k].x), bflo(x[k].y), bfhi(x[k].y)}; }
        }
    }
}
__device__ __forceinline__ void ph_gla_out(Frame& F, int l) {
    LAS unsigned char* lds = F.lds; int tid_ = F.tid; asm volatile("" : "+v"(tid_)); const int tid = tid_, lane = tid & 63, w = __builtin_amdgcn_readfirstlane(tid >> 6);
    LAS unsigned char* QD = lds + 16384; LAS unsigned char* KI = lds + 33792; LAS unsigned char* VT = lds + 51200; LAS unsigned char* PB = lds + 88064; LAS float* RS = (LAS float*)(lds + 97280);
    bf16* P = (bf16*)(F.ws + WS_PROJ); const float* SM = (const float*)(F.ws + WS_SM); const bf16* DS = (const bf16*)(F.ws + WS_AREG);
    const float* wa2l = F.wa2 + (size_t)l * 16 * 512; const float* bal = F.ba + (size_t)l * 512; const float* gn = F.gnorm + (size_t)l * 256;
    const int fr = lane & 15, fq = lane >> 4;
    for (int u = F.vcu; u < 1024; u += F.G) {
        const int bh = u >> 6, n = u & 63, b = bh >> 2, h = bh & 3, row0 = b * SEQ + n * 64;
        bf16x8 sb[2][4];
#pragma unroll
        for (int t = 0; t < 2; ++t)
#pragma unroll
            for (int s = 0; s < 4; ++s) sb[t][s] = *(const GAS bf16x8*)(DS + ((size_t)(bh * 64 + n) * 256 + (2 * w + t) * 16 + fr) * 128 + 8 * fq + 32 * s);
        float bb[16]; float blast;
        gla_gate(lds, SM, wa2l, bal, row0, h, tid, bb, blast);
        const int d = tid & 127, g = tid >> 7;
#pragma unroll
        for (int i = 0; i < 16; ++i) { const size_t ro = (size_t)(row0 + 16 * g + i) * PITCH + h * 128 + d;
            const float eb = __expf(bb[i]);
            const float qv = bf2f(P[ro + PC_GQ]) * eb * 0.08838834764831845f, kv = bf2f(P[ro + PC_GK]) * __builtin_amdgcn_rcpf(eb);
            *(LAS bf16*)(QD + (16 * g + i) * 272 + d * 2) = (bf16)f2bf(qv); *(LAS bf16*)(KI + (16 * g + i) * 272 + d * 2) = (bf16)f2bf(kv); }
        stage_vt(VT, P, row0, PC_GV + h * 256, tid);
        __syncthreads();
        { const int jt = w >> 1; f32x4 pa[2] = {(f32x4){0.f, 0.f, 0.f, 0.f}, (f32x4){0.f, 0.f, 0.f, 0.f}};
#pragma unroll
          for (int s = 0; s < 4; ++s) { const bf16x8 a = *(const LAS bf16x8*)(KI + (16 * jt + fr) * 272 + (8 * fq + 32 * s) * 2);
#pragma unroll
              for (int t = 0; t < 2; ++t) { const int ct = 2 * (w & 1) + t; const bf16x8 bq = *(const LAS bf16x8*)(QD + (16 * ct + fr) * 272 + (8 * fq + 32 * s) * 2);
                  pa[t] = __builtin_amdgcn_mfma_f32_16x16x32_bf16(a, bq, pa[t], 0, 0, 0); } }
#pragma unroll
          for (int t = 0; t < 2; ++t) { const int c = 16 * (2 * (w & 1) + t) + fr, j0 = 16 * jt + 4 * fq;
              const float v0 = (c >= j0) ? pa[t].x : 0.f, v1 = (c >= j0 + 1) ? pa[t].y : 0.f, v2 = (c >= j0 + 2) ? pa[t].z : 0.f, v3 = (c >= j0 + 3) ? pa[t].w : 0.f;
              *(LAS u32x2*)(PB + c * 144 + j0 * 2) = (u32x2){pk2(v0, v1), pk2(v2, v3)}; } }
        __syncthreads();
        f32x4 acc[4][2];
#pragma unroll
        for (int ct = 0; ct < 4; ++ct) { acc[ct][0] = (f32x4){0.f, 0.f, 0.f, 0.f}; acc[ct][1] = (f32x4){0.f, 0.f, 0.f, 0.f}; }
#pragma unroll
        for (int s = 0; s < 2; ++s) { bf16x8 bv[2];
#pragma unroll
            for (int t = 0; t < 2; ++t) bv[t] = *(const LAS bf16x8*)(VT + ((2 * w + t) * 16 + fr) * 144 + (8 * fq + 32 * s) * 2);
#pragma unroll
            for (int ct = 0; ct < 4; ++ct) { const bf16x8 a = *(const LAS bf16x8*)(PB + (16 * ct + fr) * 144 + (8 * fq + 32 * s) * 2);
                acc[ct][0] = __builtin_amdgcn_mfma_f32_16x16x32_bf16(a, bv[0], acc[ct][0], 0, 0, 0); acc[ct][1] = __builtin_amdgcn_mfma_f32_16x16x32_bf16(a, bv[1], acc[ct][1], 0, 0, 0); } }
#pragma unroll
        for (int s = 0; s < 4; ++s)
#pragma unroll
            for (int ct = 0; ct < 4; ++ct) { const bf16x8 a = *(const LAS bf16x8*)(QD + (16 * ct + fr) * 272 + (8 * fq + 32 * s) * 2);
                acc[ct][0] = __builtin_amdgcn_mfma_f32_16x16x32_bf16(a, sb[0][s], acc[ct][0], 0, 0, 0); acc[ct][1] = __builtin_amdgcn_mfma_f32_16x16x32_bf16(a, sb[1][s], acc[ct][1], 0, 0, 0); }
#pragma unroll
        for (int ct = 0; ct < 4; ++ct)
#pragma unroll
            for (int i = 0; i < 4; ++i) { float ss = acc[ct][0][i] * acc[ct][0][i] + acc[ct][1][i] * acc[ct][1][i];
                ss += __shfl_xor(ss, 1); ss += __shfl_xor(ss, 2); ss += __shfl_xor(ss, 4); ss += __shfl_xor(ss, 8);
                if (fr == 0) RS[w * 64 + 16 * ct + 4 * fq + i] = ss; }
        __syncthreads();
#pragma unroll
        for (int ct = 0; ct < 4; ++ct)
#pragma unroll
            for (int i = 0; i < 4; ++i) { const int c = 16 * ct + 4 * fq + i; float tot = 0.f;
#pragma unroll
                for (int ww = 0; ww < 8; ++ww) tot += RS[ww * 64 + c];
                const float rs = 1.0f / sqrtf(tot * (1.f / 256.f) + EPS);
#pragma unroll
                for (int t = 0; t < 2; ++t) { const int e = (2 * w + t) * 16 + fr; bf16* gp = P + (size_t)(row0 + c) * PITCH + PC_GG + h * 256 + e;
                    const float gg = bf2f(*gp); const float sg = gg * __builtin_amdgcn_rcpf(1.f + __expf(-gg));
                    *gp = (bf16)f2bf(acc[ct][t][i] * rs * gn[e] * sg); } }
    }
}

__device__ __forceinline__ size_t sc_rowoff(int b, int t) { const int qb = t >> 6; return (size_t)b * 8519680u + (size_t)64 * (64 * (qb * (qb + 1) / 2) + (t & 63) * (qb + 1)); }
__device__ __forceinline__ void index_unit(Frame& F, int b, int qg) {
    LAS unsigned char* KL = F.lds; int tid_ = F.tid; asm volatile("" : "+v"(tid_)); const int tid = tid_, lane = tid & 63, w = __builtin_amdgcn_readfirstlane(tid >> 6);
    const bf16* P = (const bf16*)(F.ws + WS_PROJ); const float* SM = (const float*)(F.ws + WS_SM); const bf16* IKB = (const bf16*)(F.ws + WS_IKB); float* SC = (float*)(F.ws + WS_SC);
    const int t0 = 16 * qg + 2 * w; const int r = lane & 31, hi = lane >> 5;
    const int qsel = (r >> 2) & 1, hsel = (r & 3) + 4 * (r >> 3);
    bf16x8 a[4];
#pragma unroll
    for (int s = 0; s < 4; ++s) a[s] = *(const GAS bf16x8*)(P + (size_t)(b * SEQ + t0 + qsel) * PITCH + PC_IQ + hsel * 64 + 16 * s + 8 * hi);
    float wt[16];
#pragma unroll
    for (int q4 = 0; q4 < 4; ++q4) { const f32x4 v = *(const GAS f32x4*)(SM + (size_t)(b * SEQ + t0 + hi) * 128 + 80 + 4 * q4);
        wt[4 * q4] = v.x * 0.03125f; wt[4 * q4 + 1] = v.y * 0.03125f; wt[4 * q4 + 2] = v.z * 0.03125f; wt[4 * q4 + 3] = v.w * 0.03125f; }
    float* srow = SC + sc_rowoff(b, t0 + hi);
    const int nchunk = (16 * qg + 15) / 256 + 1;
    for (int ch = 0; ch < nchunk; ++ch) {
        __syncthreads();
#pragma unroll
        for (int i = 0; i < 4; ++i) { const int p = tid + 512 * i, key = p >> 3, c16 = p & 7;
            *(LAS v4u*)(KL + key * 144 + 16 * c16) = *(const GAS v4u*)(IKB + (size_t)(b * SEQ + 256 * ch + key) * 64 + 8 * c16); }
        __syncthreads();
#pragma unroll
        for (int tl = 0; tl < 8; ++tl) { const int k0 = 256 * ch + 32 * tl;
            if (k0 <= t0 + 1) {
                f32x16 acc = {};
#pragma unroll
                for (int s = 0; s < 4; ++s) { const bf16x8 bk = *(const LAS bf16x8*)(KL + (32 * tl + r) * 144 + (16 * s + 8 * hi) * 2);
                    acc = __builtin_amdgcn_mfma_f32_32x32x16_bf16(a[s], bk, acc, 0, 0, 0); }
                float sc = 0.f;
#pragma unroll
                for (int i = 0; i < 16; ++i) sc = fmaf(wt[i], fmaxf(acc[i], 0.f), sc);
                srow[k0 + r] = sc; } }
    }
}
__device__ __forceinline__ void ph_index(Frame& F) {
    for (int it = F.vcu; it < 512; it += F.G) { const int b = it >> 7, x = it & 127;
        index_unit(F, b, x); index_unit(F, b, 255 - x); }
}
__device__ __forceinline__ void topk_row(Frame& F, int b, int t) {
    const float* SC = (const float*)(F.ws + WS_SC); unsigned long long* MASK = (unsigned long long*)(F.ws + WS_MASK);
    int lane_ = F.lane; asm volatile("" : "+v"(lane_)); const int lane = lane_; const float* srow = SC + sc_rowoff(b, t);
    unsigned ku[64];
#pragma unroll
    for (int g8 = 0; g8 < 8; ++g8) {
        if (g8 * 512 <= t) {
#pragma unroll
            for (int k = 0; k < 8; ++k) { const int j = g8 * 8 + k; const int key = 64 * j + lane;
                const int kc = key <= t ? key : t;
                const unsigned u = __float_as_uint(srow[kc]); const unsigned mp = (u & 0x80000000u) ? ~u : (u | 0x80000000u);
                ku[j] = key <= t ? mp : 0u; }
        } else {
#pragma unroll
            for (int k = 0; k < 8; ++k) ku[g8 * 8 + k] = 0u;
        }
    }
    unsigned prefix = 1u;
    if (t >= 256) {
        prefix = 0u;
        for (int bit = 31; bit >= 0; --bit) {
            const unsigned cand = prefix | (1u << bit); int cnt = 0;
#pragma unroll
            for (int j = 0; j < 64; ++j) cnt += (ku[j] >= cand) ? 1 : 0;
#pragma unroll
            for (int o = 1; o < 64; o <<= 1) cnt += __shfl_xor(cnt, o);
            if (cnt >= 256) prefix = cand;
            if (cnt == 256) break;
        }
    }
    unsigned mlo = 0u, mhi = 0u;
#pragma unroll
    for (int j = 0; j < 64; ++j) { const unsigned long long bal = __ballot(ku[j] >= prefix); if (lane == j) { mlo = (unsigned)bal; mhi = (unsigned)(bal >> 32); } }
    MASK[((size_t)b * 64 + lane) * SEQ + t] = ((unsigned long long)mhi << 32) | mlo;
}
__device__ __forceinline__ void ph_topk(Frame& F) {
    for (int grp = F.vcu; grp < 1024; grp += F.G) { const int b = grp >> 8, tb = (grp & 255) * 16;
        topk_row(F, b, tb + F.wave); topk_row(F, b, tb + 8 + F.wave); }
}

namespace att {
constexpr int D = 128, NW = 8, QBLK = 32, KVBLK = 64, QB = NW * QBLK;
constexpr int SHM_V = KVBLK * D * 2, SHM_K = KVBLK * D * 2;
constexpr int LDS_BYTES = 2 * SHM_V + 2 * SHM_K + NW * 64 * 4;
constexpr float SCALE = 0.08838834764831845f, THR = 8.f;
typedef short s16x4 __attribute__((ext_vector_type(4)));
typedef unsigned u32x4 __attribute__((ext_vector_type(4)));
#define KSWZ(row, colB) ((row) * 256 + ((colB) ^ (((row) & 7) << 4)))
#define SBAR() __builtin_amdgcn_sched_barrier(0)
__device__ __forceinline__ int v_st(int k, int c) { const int kk = (k & ~0xC) | ((k & 4) << 1) | ((k & 8) >> 1); return ((kk >> 3) * 4 + (c >> 5)) * 512 + ((kk & 7) * 32 + (c & 31)) * 2; }
__device__ __forceinline__ int v_rd_base(int lane) { return ((lane & 3) << 3) | (((lane >> 2) & 3) << 6) | (((lane >> 4) & 1) << 5) | (((lane >> 5) & 1) << 8); }
constexpr int v_rd_off(int d0, int ks, int half) { return d0 * 512 + ks * 4096 + half * 2048; }
__device__ __forceinline__ int crow(int r, int hi) { return (r & 3) + 8 * (r >> 2) + 4 * hi; }
__device__ __forceinline__ unsigned cvtpk(float lo, float hi) { unsigned r; asm volatile("v_cvt_pk_bf16_f32 %0, %1, %2" : "=v"(r) : "v"(lo), "v"(hi)); return r; }
__device__ __forceinline__ bf16x8 load8(const bf16* p) { return *reinterpret_cast<const bf16x8*>(p); }
__device__ __forceinline__ void mask_bits(f32x16& p0, f32x16& p1, unsigned mlo, unsigned mhi) {
    const float NEG = -__builtin_inff();
#pragma unroll
    for (int r = 0; r < 16; ++r) { const int c = (r & 3) + 8 * (r >> 2);
        if (!((mlo >> c) & 1u)) p0[r] = NEG;
        if (!((mhi >> c) & 1u)) p1[r] = NEG; }
}
__device__ __forceinline__ void partialSM(f32x16& p0, f32x16& p1, float& m_reg, float& mn, float& alpha) {
    float pmax = p0[0]; for (int r = 1; r < 16; ++r) pmax = fmaxf(pmax, p0[r]); for (int r = 0; r < 16; ++r) pmax = fmaxf(pmax, p1[r]);
    { auto rr = __builtin_amdgcn_permlane32_swap(__float_as_uint(pmax), __float_as_uint(pmax), false, false);
      pmax = fmaxf(__uint_as_float(rr[0]), __uint_as_float(rr[1])); }
    constexpr float C2 = 1.4426950408889634f * SCALE;
    if (__builtin_expect(__all((pmax - m_reg) * SCALE <= THR), 1)) { mn = m_reg; alpha = 1.f; }
    else { mn = fmaxf(m_reg, pmax); alpha = __builtin_amdgcn_exp2f((m_reg - mn) * C2); m_reg = mn; }
    const float mnL = -mn * C2;
    for (int r = 0; r < 16; ++r) p0[r] = fmaf(p0[r], C2, mnL); for (int r = 0; r < 16; ++r) p1[r] = fmaf(p1[r], C2, mnL);
    for (int r = 0; r < 16; ++r) p0[r] = __builtin_amdgcn_exp2f(p0[r]);
}
__device__ __forceinline__ void finishSM(f32x16& p0, f32x16& p1, float alpha, float& l_reg, bf16x8& pa0, bf16x8& pa1, bf16x8& pa2, bf16x8& pa3) {
    for (int r = 0; r < 16; ++r) p1[r] = __builtin_amdgcn_exp2f(p1[r]);
    float ps = 0; for (int r = 0; r < 16; ++r) ps += p0[r]; for (int r = 0; r < 16; ++r) ps += p1[r];
    { auto rr = __builtin_amdgcn_permlane32_swap(__float_as_uint(ps), __float_as_uint(ps), false, false);
      ps = __uint_as_float(rr[0]) + __uint_as_float(rr[1]); }
    l_reg = l_reg * alpha + ps;
#define PK4(P, B_, OUT) do { unsigned a0 = cvtpk(P[B_+0], P[B_+1]), a1 = cvtpk(P[B_+2], P[B_+3]);                          \
        unsigned b0 = cvtpk(P[B_+4], P[B_+5]), b1 = cvtpk(P[B_+6], P[B_+7]);                                             \
        auto r0 = __builtin_amdgcn_permlane32_swap(a0, b0, false, false); auto r1 = __builtin_amdgcn_permlane32_swap(a1, b1, false, false); \
        u32x4 w = {r0[0], r1[0], r0[1], r1[1]}; OUT = *reinterpret_cast<bf16x8*>(&w); } while (0)
    PK4(p0, 0, pa0); PK4(p0, 8, pa1); PK4(p1, 0, pa2); PK4(p1, 8, pa3);
#undef PK4
}
template <int KB>
__device__ __forceinline__ void qkt(f32x16& p0, f32x16& p1, const char* K_lds, int r32, int hi, const bf16x8* qr) {
    p0 = f32x16{}; p1 = f32x16{};
    const char* kb[4];
#pragma unroll
    for (int dd = 0; dd < 4; ++dd) kb[dd] = K_lds + KB * SHM_K + KSWZ(r32, (dd * 16 + hi * 8) * 2);
#pragma unroll
    for (int d0 = 0; d0 < 8; ++d0) { const char* a = kb[d0 & 3] + (d0 >> 2) * 128;
        bf16x8 b0 = *reinterpret_cast<const bf16x8*>(a);
        bf16x8 b1 = *reinterpret_cast<const bf16x8*>(a + 32 * 256);
        p0 = __builtin_amdgcn_mfma_f32_32x32x16_bf16(b0, qr[d0], p0, 0, 0, 0);
        p1 = __builtin_amdgcn_mfma_f32_32x32x16_bf16(b1, qr[d0], p1, 0, 0, 0); }
}
template <int VB>
__device__ __forceinline__ void pv_tile(f32x16* o, int vb0, bf16x8 pa0, bf16x8 pa1, bf16x8 pa2, bf16x8 pa3) {
#define TRRD(dst, off) asm volatile("ds_read_b64_tr_b16 %0, %1 offset:%2" : "=&v"(dst) : "v"(vb0), "i"(off) : "memory")
#define PV_D0(d0) do { s16x4 l0, l1, l2, l3, h0, h1, h2, h3; constexpr int b_ = VB * SHM_V + v_rd_off(d0, 0, 0); \
        TRRD(l0, b_); TRRD(h0, b_ + 2048); TRRD(l1, b_ + 4096); TRRD(h1, b_ + 6144); TRRD(l2, b_ + 8192); TRRD(h2, b_ + 10240); TRRD(l3, b_ + 12288); TRRD(h3, b_ + 14336); \
        asm volatile("s_waitcnt lgkmcnt(0)" ::: "memory"); SBAR();   \
        o[d0] = __builtin_amdgcn_mfma_f32_32x32x16_bf16(pa0, (bf16x8){l0[0], l0[1], l0[2], l0[3], h0[0], h0[1], h0[2], h0[3]}, o[d0], 0, 0, 0);   \
        o[d0] = __builtin_amdgcn_mfma_f32_32x32x16_bf16(pa1, (bf16x8){l1[0], l1[1], l1[2], l1[3], h1[0], h1[1], h1[2], h1[3]}, o[d0], 0, 0, 0);   \
        o[d0] = __builtin_amdgcn_mfma_f32_32x32x16_bf16(pa2, (bf16x8){l2[0], l2[1], l2[2], l2[3], h2[0], h2[1], h2[2], h2[3]}, o[d0], 0, 0, 0);   \
        o[d0] = __builtin_amdgcn_mfma_f32_32x32x16_bf16(pa3, (bf16x8){l3[0], l3[1], l3[2], l3[3], h3[0], h3[1], h3[2], h3[3]}, o[d0], 0, 0, 0); } while (0)
    PV_D0(0); PV_D0(1); PV_D0(2); PV_D0(3);
#undef PV_D0
#undef TRRD
}
struct BlockRef { const bf16* Q; const bf16* K; const bf16* V; bf16* O; const unsigned long long* MK; int P0; };
struct Seam { bf16x8 qr[8]; bf16x8 st_v0, st_v1, st_k0, st_k1; };
#define ROW(p, k0, rr) ((p) + (size_t)((k0) + (rr)) * PITCH + sc)
#define VMW() asm volatile("s_waitcnt vmcnt(0)" ::: "memory")
#define VMWN(n) asm volatile("s_waitcnt vmcnt(%0)" :: "i"(n) : "memory")
#define SLOAD_H(Kp, Vp, k0) do { S.st_v0 = load8(ROW(Vp, k0, sr)); S.st_v1 = load8(ROW(Vp, k0, 32 + sr));              \
                         S.st_k0 = load8(ROW(Kp, k0, sr)); S.st_k1 = load8(ROW(Kp, k0, 32 + sr)); } while (0)
#define SWRITE_HK(bf) do { *(bf16x8*)(K_lds + (bf) * SHM_K + kws) = S.st_k0; *(bf16x8*)(K_lds + (bf) * SHM_K + kws + 32 * 256) = S.st_k1; } while (0)
#define SWRITE_HV(bf) do { *(bf16x8*)(V_lds + (bf) * SHM_V + vst0) = S.st_v0; *(bf16x8*)(V_lds + (bf) * SHM_V + vst1) = S.st_v1; } while (0)
#define SWRITE_H(bf) do { SWRITE_HV(bf); SWRITE_HK(bf); } while (0)
__device__ __forceinline__ void prime(const BlockRef& cur, char* lds, Seam& S) {
    int tid_ = threadIdx.x; asm volatile("" : "+v"(tid_));
    const int tid = tid_, wid = __builtin_amdgcn_readfirstlane(tid >> 6), lane = tid & 63, r32 = lane & 31, hi = lane >> 5;
    const int sr = tid >> 4, sc = (tid & 15) * 8, kws = KSWZ(sr, sc * 2); char* K_lds = lds + 2 * SHM_V;
    for (int d0 = 0; d0 < 8; ++d0) S.qr[d0] = load8(cur.Q + (size_t)(wid * QBLK + r32) * PITCH + d0 * 16 + hi * 8);
    SLOAD_H(cur.K, cur.V, 0); VMW(); SWRITE_HK(0);
    __syncthreads();
}
__device__ __forceinline__ void block(const BlockRef& cur, const BlockRef& nxt, char* lds, Seam& S) {
    int tid_ = threadIdx.x; asm volatile("" : "+v"(tid_));
    const int tid = tid_, wid = __builtin_amdgcn_readfirstlane(tid >> 6), lane = tid & 63, r32 = lane & 31, hi = lane >> 5;
    const int NT = (cur.P0 + QB - 1) / KVBLK + 1;
    char* V_lds = lds; char* K_lds = lds + 2 * SHM_V;
    float* ws = (float*)(lds + 2 * SHM_V + 2 * SHM_K) + wid * 64; float* li_l = ws, * al_l = ws + 32;
    float m_reg = -1e30f, l_reg = 0; f32x16 o[4] = {};
    const int sr = tid >> 4, sc = (tid & 15) * 8, vst0 = v_st(sr, sc), vst1 = v_st(32 + sr, sc), kws = KSWZ(sr, sc * 2);
    const int vb0 = (int)(uintptr_t)V_lds + v_rd_base(lane);
    const bf16* Kh = cur.K; const bf16* Vh = cur.V;
    const unsigned long long* mkp = cur.MK + wid * QBLK + r32;
#define RESC(a) do { if (__any((a) < 1.f)) { if (hi == 0) al_l[r32] = (a); asm volatile("s_waitcnt lgkmcnt(0)" ::: "memory");              \
                     for (int d_ = 0; d_ < 4; ++d_) for (int r = 0; r < 16; ++r) o[d_][r] *= al_l[crow(r, hi)]; } } while (0)
#define KBASE(t) ((t) * KVBLK)
#define MLOAD(t) (mkp[(size_t)(t) * SEQ])
#define MASKT(P0_, P1_, mw_) do { const unsigned long long m_ = (mw_); mask_bits(P0_, P1_, ((unsigned)m_) >> (4 * hi), ((unsigned)(m_ >> 32)) >> (4 * hi)); } while (0)
    constexpr int NQL = 8;
#define SEAM_K0() do { VMWN(NQL); SWRITE_HK(0); SBAR(); } while (0)
    f32x16 pA0, pA1, pB0, pB1; float mnA, mnB, alA, alB; bf16x8 pa0, pa1, pa2, pa3;
    unsigned long long mwA, mwB;
    SWRITE_HV(0); SBAR();
    mwA = MLOAD(0);
    if (NT > 1) { SLOAD_H(Kh, Vh, KBASE(1)); }
    SBAR(); qkt<0>(pA0, pA1, K_lds, r32, hi, S.qr);
    MASKT(pA0, pA1, mwA); partialSM(pA0, pA1, m_reg, mnA, alA);
    if (NT > 1) { VMW(); SWRITE_H(1); }
    __syncthreads();
#define HALF_STEP(PX0, PX1, mnX, alX, mwX, PY0, PY1, alY, t, KB, VB, SB) do {                                                      \
        SBAR(); mwX = MLOAD(t); qkt<KB>(PX0, PX1, K_lds, r32, hi, S.qr);                                             \
        finishSM(PY0, PY1, alY, l_reg, pa0, pa1, pa2, pa3); SBAR();                                                           \
        if ((t) + 1 < NT) { SLOAD_H(Kh, Vh, KBASE((t) + 1)); SBAR(); }                                               \
        pv_tile<VB>(o, vb0, pa0, pa1, pa2, pa3); MASKT(PX0, PX1, mwX); partialSM(PX0, PX1, m_reg, mnX, alX);                                        \
        __syncthreads();                                                                                                      \
        if ((t) + 1 < NT) { VMW(); SWRITE_H(SB); }                                                                          \
        RESC(alX); __syncthreads(); } while (0)
    for (int t = 1; t + 1 < NT; t += 2) {
        HALF_STEP(pB0, pB1, mnB, alB, mwB, pA0, pA1, alA, t, 1, 0, 0);
        HALF_STEP(pA0, pA1, mnA, alA, mwA, pB0, pB1, alB, t + 1, 0, 1, 1);
    }
    SBAR(); mwB = MLOAD(NT - 1); qkt<1>(pB0, pB1, K_lds, r32, hi, S.qr); SBAR();
    SLOAD_H(nxt.K, nxt.V, 0); SBAR();
#pragma unroll
    for (int d0 = 0; d0 < 8; ++d0) S.qr[d0] = load8(nxt.Q + (size_t)(wid * QBLK + r32) * PITCH + d0 * 16 + hi * 8);
    SBAR();
    finishSM(pA0, pA1, alA, l_reg, pa0, pa1, pa2, pa3); SBAR();
    pv_tile<0>(o, vb0, pa0, pa1, pa2, pa3);
    MASKT(pB0, pB1, mwB); partialSM(pB0, pB1, m_reg, mnB, alB); __syncthreads(); RESC(alB);
    finishSM(pB0, pB1, alB, l_reg, pa0, pa1, pa2, pa3); SBAR(); pv_tile<1>(o, vb0, pa0, pa1, pa2, pa3);
    SBAR(); SEAM_K0();
    if (hi == 0) li_l[r32] = l_reg; asm volatile("s_waitcnt lgkmcnt(0)" ::: "memory");
    float rli[16];
#pragma unroll
    for (int r = 0; r < 16; ++r) rli[r] = __builtin_amdgcn_rcpf(li_l[crow(r, hi)]);
    bf16* Ow = cur.O + (size_t)(wid * QBLK) * PITCH;
#pragma unroll
    for (int r = 0; r < 16; ++r) { const int orow = crow(r, hi);
#pragma unroll
        for (int d0 = 0; d0 < 4; ++d0) { const float v = o[d0][r] * rli[r];
            const float vn = __shfl_xor(v, 1);
            if ((r32 & 1) == 0) *(unsigned*)(Ow + (size_t)orow * PITCH + d0 * 32 + r32) = cvtpk(v, vn); } }
    __syncthreads();
#undef RESC
#undef KBASE
#undef MLOAD
#undef MASKT
#undef SEAM_K0
#undef HALF_STEP
}
#undef ROW
#undef VMW
#undef VMWN
#undef SLOAD_H
#undef SWRITE_HK
#undef SWRITE_HV
#undef SWRITE_H
#undef KSWZ
#undef SBAR
}
__device__ __forceinline__ att::BlockRef attn_ref(Frame& F, int bh, int qb) {
    bf16* P = (bf16*)(F.ws + WS_PROJ); const unsigned long long* MASK = (const unsigned long long*)(F.ws + WS_MASK);
    const int b = bh >> 3, h = bh & 7; att::BlockRef r;
    r.Q = P + (size_t)(b * SEQ + qb * 256) * PITCH + PC_DQ + h * 128; r.O = P + (size_t)(b * SEQ + qb * 256) * PITCH + PC_DQ + h * 128;
    r.K = P + (size_t)(b * SEQ) * PITCH + PC_DK + h * 128; r.V = P + (size_t)(b * SEQ) * PITCH + PC_DV + h * 128;
    r.MK = MASK + (size_t)b * 64 * SEQ + qb * 256; r.P0 = qb * 256; return r;
}
__device__ __forceinline__ void ph_attn(Frame& F, char* lds) {
    int L = F.vcu; if (L >= 256) return;
    int pass = 0; att::BlockRef cur = attn_ref(F, L >> 3, L & 7);
    att::Seam S; att::prime(cur, lds, S);
    for (;;) {
        const bool more_item = L + F.G < 256, last = (pass == 1) && !more_item;
        int Ln = L, passn = pass + 1; if (pass == 1) { passn = 0; Ln = more_item ? L + F.G : L; }
        const att::BlockRef nxt = last ? cur : attn_ref(F, Ln >> 3, passn ? 15 - (Ln & 7) : (Ln & 7));
        att::block(cur, nxt, lds, S);
        if (last) break;
        cur = nxt; pass = passn; L = Ln;
    }
}

__device__ __forceinline__ void ph_residual(Frame& F, const bf16* src, int lds_src, const float* hbase, const float* gp, const float* gn, bf16* adst, bool write_a) {
    const int gw = F.vcu * NWAVES + F.wave, NGW = F.G * NWAVES;
    for (int m = gw; m < M; m += NGW) residual_row(src + (size_t)m * lds_src, hbase + (size_t)m * DM, gp, F.out + (size_t)m * DM, gn, adst + (size_t)m * DM, write_a, F.lane);
}
__device__ __forceinline__ void ph_prologue(Frame& F) {
    rope_tables(F);
    convert_weights(F, 0, 0);
    const int gw = F.vcu * NWAVES + F.wave, NGW = F.G * NWAVES;
    for (int m = gw; m < M; m += NGW) norm_row_to_bf16(F.x + (size_t)m * DM, F.g_pre, (bf16*)(F.ws + WS_AREG) + (size_t)m * DM, F.lane);
}

#ifndef MK_ONE_LAUNCH
#define MK_ONE_LAUNCH 0
#endif
struct Args { const float* in[13]; float* out; unsigned char* ws; int ph_lo, ph_hi; };
#define LAYER_BODY(l) do { \
        const int p0 = 1 + 9 * l; \
        \
        if (IN(p0)) { \
            pg8::Gemm g{AREG, (const bf16*)(F.ws + WS_WIN), M, NIN, DM, DM}; pg8::StaticOrder S; S.init(M, NIN, F.G, (int)blockIdx.x); \
            pg8::EpiIn E{PROJ, (float*)(F.ws + WS_SM), (bf16*)(F.ws + WS_IKB), (const float*)(F.ws + WS_CA), (const float*)(F.ws + WS_SA), (const float*)(F.ws + WS_CI), (const float*)(F.ws + WS_SI)}; \
            pg8::gemm_phase<pg8::EpiIn, pg8::StaticOrder, true, true>(F.lds, g, S, E); \
            SEAM(p0); \
        } \
        \
        if (IN(p0 + 1)) { ph_gla_local(F, l); __syncthreads(); ph_index(F); SEAM(p0 + 1); } \
        \
        if (IN(p0 + 2)) { ph_gla_scan(F); ph_topk(F); SEAM(p0 + 2); } \
        \
        if (IN(p0 + 3)) { \
\
            ph_gla_out(F, l); __syncthreads(); \
\
\
            ph_attn(F, (char*)lds); \
\
            SEAM(p0 + 3); } \
        \
        if (IN(p0 + 4)) { \
            pg8::Gemm g{PROJ + PC_O, (const bf16*)(F.ws + WS_WOUT), M, DM, DM, PITCH}; pg8::StaticOrder S; S.init(M, DM, F.G, (int)blockIdx.x); \
            pg8::EpiStore<0> E{PROJ + PC_MX, PITCH}; \
            pg8::gemm_phase<pg8::EpiStore<0>, pg8::StaticOrder, true, true>(F.lds, g, S, E); \
            SEAM(p0 + 4); \
        } \
        \
        if (IN(p0 + 5)) { \
            ph_residual(F, PROJ + PC_MX, PITCH, l == 0 ? F.x : F.out, F.g_post + (size_t)l * DM, F.g_fpre + (size_t)l * DM, AREG, true); \
            __syncthreads(); convert_weights(F, l, 1); \
            SEAM(p0 + 5); \
        } \
        \
        if (IN(p0 + 6)) { \
            pg8::Gemm g{AREG, (const bf16*)(F.ws + WS_WUP), M, DFF, DM, DM}; pg8::StaticOrder S; S.init(M, DFF, F.G, (int)blockIdx.x); \
            pg8::EpiStore<2> E{PROJ, DFF}; \
            pg8::gemm_phase<pg8::EpiStore<2>, pg8::StaticOrder, true, true>(F.lds, g, S, E); \
            SEAM(p0 + 6); \
        } \
        \
        if (IN(p0 + 7)) { \
            pg8::Gemm g{PROJ, (const bf16*)(F.ws + WS_WDN), M, DM, DFF, DFF}; pg8::StaticOrder S; S.init(M, DM, F.G, (int)blockIdx.x); \
            pg8::EpiStore<0> E{AREG, DM}; \
            pg8::gemm_phase<pg8::EpiStore<0>, pg8::StaticOrder, true, true>(F.lds, g, S, E); \
            SEAM(p0 + 7); \
        } \
        \
        if (IN(p0 + 8)) { \
            const bool more = (l + 1 < DEPTH); \
            ph_residual(F, AREG, DM, F.out, F.g_fpost + (size_t)l * DM, F.g_pre + (size_t)(more ? l + 1 : l) * DM, AREG, more); \
            if (more) { __syncthreads(); convert_weights(F, l + 1, 0); } \
            SEAM(p0 + 8); \
        } \
    } while (0)
__global__ void __launch_bounds__(NTHREADS, 2) mk_fwd(Args args) {
    extern __shared__ __attribute__((aligned(16))) unsigned char lds[];
    Frame F;
    F.lds = (LAS unsigned char*)lds; F.MISC = (volatile LAS unsigned*)(F.lds + MISC_OFF);
    F.tid = threadIdx.x; F.lane = F.tid & 63; F.wave = __builtin_amdgcn_readfirstlane(F.tid >> 6);
    F.G = gridDim.x; { const int bx = blockIdx.x; F.vcu = (F.G % 8 == 0) ? (bx % 8) * (F.G / 8) + bx / 8 : bx; }
    F.ws = args.ws; F.ctl = (gu32*)(args.ws + WS_CTL);
    F.x = args.in[0]; F.pos = (const int*)args.in[1]; F.g_pre = args.in[2]; F.w_in = args.in[3]; F.wa2 = args.in[4]; F.ba = args.in[5]; F.gnorm = args.in[6]; F.w_out = args.in[7];
    F.g_post = args.in[8]; F.g_fpre = args.in[9]; F.w_up = args.in[10]; F.w_down = args.in[11]; F.g_fpost = args.in[12]; F.out = args.out;
    for (int u = F.tid; u < (LDS_BYTES - LDSCTL_OFF) / 4; u += NTHREADS) ((LAS unsigned*)(F.lds + LDSCTL_OFF))[u] = 0u;
    __syncthreads();
    const int lo = args.ph_lo, hi = args.ph_hi;
    XcdBarrier bar; bar.bar = (unsigned*)(F.ctl + CW_BAR); bar.x = 0; bar.st = nullptr;
    if (hi - lo > 1) bar = xcd_barrier_post((unsigned*)(F.ctl + CW_BAR), F.MISC + 8);
#ifndef PH_MASK
#define PH_MASK 0x3ff
#endif
#define PHCLS(k) ((k) == 0 ? 0 : 1 + ((k) - 1) % 9)
#define IN(k) (lo <= (k) && (k) < hi && ((PH_MASK >> PHCLS(k)) & 1))
#define SEAM(k) do { if (IN(k) && IN((k) + 1)) xcd_barrier(bar); } while (0)
    bf16* const AREG = (bf16*)(F.ws + WS_AREG); bf16* const PROJ = (bf16*)(F.ws + WS_PROJ);

    if (IN(0)) { ph_prologue(F); SEAM(0); }

    LAYER_BODY(0);
    LAYER_BODY(1);
#undef IN
#undef SEAM
}

extern "C" void kernel_launch(void* const* d_in, const int* in_sizes, int n_in, void* d_out, int out_size, void* d_ws, size_t ws_size, hipStream_t stream) {
    static int grid = 0;
    if (grid == 0) {
        if (n_in != 13 || in_sizes[0] != M * DM || out_size != M * DM || ws_size < WS_END) { fprintf(stderr, "kernel_launch: unexpected shapes / workspace (n_in %d, ws %zu < %zu); nothing launched\n", n_in, ws_size, (size_t)WS_END); grid = -1; return; }
        int dev = 0, cus = 0, per_cu = 0;
        if (hipGetDevice(&dev) != hipSuccess || hipDeviceGetAttribute(&cus, hipDeviceAttributeMultiprocessorCount, dev) != hipSuccess) { grid = -1; return; }
        if (hipFuncSetAttribute((const void*)mk_fwd, hipFuncAttributeMaxDynamicSharedMemorySize, LDS_BYTES) != hipSuccess) { fprintf(stderr, "kernel_launch: hipFuncSetAttribute failed\n"); grid = -1; return; }
        if (hipOccupancyMaxActiveBlocksPerMultiprocessor(&per_cu, (const void*)mk_fwd, NTHREADS, LDS_BYTES) != hipSuccess || per_cu < 1) { fprintf(stderr, "kernel_launch: occupancy query says %d blocks per CU\n", per_cu); }
        (void)hipGetLastError();
        grid = cus;
    }
    if (grid < 0) return;
    if (hipMemsetAsync((char*)d_ws + WS_CTL, 0, CTL_ZERO_BYTES, stream) != hipSuccess) return;
    Args a{};
    for (int i = 0; i < 13; ++i) a.in[i] = (const float*)d_in[i];
    a.out = (float*)d_out; a.ws = (unsigned char*)d_ws;
#if MK_ONE_LAUNCH
    a.ph_lo = 0; a.ph_hi = NPHASE;
    hipLaunchKernelGGL(mk_fwd, dim3(grid), dim3(NTHREADS), LDS_BYTES, stream, a);
#else
    for (int p = 0; p < NPHASE; ++p) { a.ph_lo = p; a.ph_hi = p + 1; hipLaunchKernelGGL(mk_fwd, dim3(grid), dim3(NTHREADS), LDS_BYTES, stream, a); }
#endif
}
```
